# Optimizing an MI355X kernel written in HIP

```python
import math
import jax, jax.numpy as jnp
from jax import lax
import numpy as np

D_MODEL = 1024
BATCH = 32
SEQ = 256
DEPTH = 2
DEC_BATCH = 2
DEC_SEQ = 1024
PAST_LEN = 512

GRID_W = 64
HEAD_DIM = 64
ROPE_BASE = 10000.0
H_RET = 8
RET_CHUNK = 128
H_WIN = 8
KV_WIN = 2
G_WIN = H_WIN // KV_WIN
WINDOW = 128
Q_BLOCK = 128
H_DIFF = 6
FNET_GROUPS = 4
FNET_DIM = 64
D_FF = 256 * math.ceil(8 * D_MODEL / 3 / 256)
N_AB = (DEPTH + 1) // 2
N_CD = DEPTH // 2
AB_IN = 4 * H_RET * HEAD_DIM + (H_WIN + 2 * KV_WIN) * HEAD_DIM
AB_OUT = (H_RET + H_WIN) * HEAD_DIM
CD_IN = 3 * H_DIFF * 2 * HEAD_DIM + FNET_GROUPS * FNET_DIM
CD_OUT = H_DIFF * 2 * HEAD_DIM + FNET_GROUPS * FNET_DIM
ALPHA = (2 * DEPTH) ** 0.25
BETA = (8 * DEPTH) ** -0.25
LN_EPS = 1e-5

kernel_name = 'hybrid_retention_window_diff_fnet_dit_step'

f32 = jnp.float32


def layer_norm(x, g=None, b=None):
    xf = x.astype(f32)
    mu = jnp.mean(xf, -1, keepdims=True)
    var = jnp.mean(jnp.square(xf - mu), -1, keepdims=True)
    y = (xf - mu) * lax.rsqrt(var + LN_EPS)
    if g is not None:
        y = y * g.astype(f32) + b.astype(f32)
    return y.astype(x.dtype)


def rms_norm(x, g):
    xf = x.astype(f32)
    y = xf * lax.rsqrt(jnp.mean(jnp.square(xf), -1, keepdims=True) + LN_EPS) * g.astype(f32)
    return y.astype(x.dtype)


def axial_rope(n_tokens, dim):
    rows = n_tokens // GRID_W
    r, col = jnp.meshgrid(jnp.arange(rows), jnp.arange(GRID_W), indexing='ij')
    r = r.reshape(-1).astype(f32)
    col = col.reshape(-1).astype(f32)
    quarter = dim // 4
    inv = ROPE_BASE ** (-jnp.arange(quarter, dtype=f32) / quarter)
    ang = jnp.concatenate([r[:, None] * inv, col[:, None] * inv], -1)
    return jnp.cos(ang), jnp.sin(ang)


def apply_rope(x, cos, sin):
    half = x.shape[-1] // 2
    shape = (1, x.shape[1]) + (1,) * (x.ndim - 3) + (half,)
    cos = cos.reshape(shape)
    sin = sin.reshape(shape)
    xf = x.astype(f32)
    x1, x2 = xf[..., :half], xf[..., half:]
    return jnp.concatenate([x1 * cos - x2 * sin, x1 * sin + x2 * cos], -1).astype(x.dtype)


def map_query_blocks(fn, q):
    B, T = q.shape[:2]
    nb = T // Q_BLOCK

    def body(n):
        start = n * Q_BLOCK
        return fn(lax.dynamic_slice_in_dim(q, start, Q_BLOCK, axis=1), start)

    out = jnp.moveaxis(lax.map(body, jnp.arange(nb)), 0, 1)
    return out.reshape((B, T) + out.shape[3:])


def gqa_attend(q, k, v, mask, sink):
    s = jnp.einsum('bqhgd,bkhd->bhgqk', q, k).astype(f32) * (q.shape[-1] ** -0.5)
    if mask is not None:
        s = jnp.where(mask, s, -jnp.inf)
    sink_col = jnp.broadcast_to(sink.astype(f32)[None, :, :, None, None], s.shape[:-1] + (1,))
    p = jax.nn.softmax(jnp.concatenate([s, sink_col], -1), axis=-1)[..., :-1]
    return jnp.einsum('bhgqk,bkhd->bqhgd', p.astype(v.dtype), v)


def window_attention_latent(q, k, v, ctx_k, ctx_v, sink):
    T = q.shape[1]
    Tc = ctx_k.shape[1]
    pad = ((0, 0), (Q_BLOCK, Q_BLOCK), (0, 0), (0, 0))
    kp = jnp.pad(k, pad)
    vp = jnp.pad(v, pad)
    a = jnp.arange(Q_BLOCK)[:, None]
    b = jnp.arange(3 * Q_BLOCK)[None, :]
    band = jnp.abs(a - b + Q_BLOCK) <= WINDOW
    ctx_mask = jnp.ones((Q_BLOCK, Tc), bool)

    def block(qb, start):
        kb = lax.dynamic_slice_in_dim(kp, start, 3 * Q_BLOCK, axis=1)
        vb = lax.dynamic_slice_in_dim(vp, start, 3 * Q_BLOCK, axis=1)
        j = start - Q_BLOCK + b
        mask = jnp.concatenate([band & (j >= 0) & (j < T), ctx_mask], 1)
        return gqa_attend(qb, jnp.concatenate([kb, ctx_k], 1), jnp.concatenate([vb, ctx_v], 1), mask, sink)

    return map_query_blocks(block, q)


def retention_chunkwise(q, k, v, log_gamma, s0):
    B, H, T, _ = q.shape
    dv = v.shape[-1]
    n = T // RET_CHUNK

    def chunks(x):
        return jnp.moveaxis(x.reshape(B, H, n, RET_CHUNK, x.shape[-1]), 2, 0)

    idx = jnp.arange(RET_CHUNK, dtype=f32)
    lg = log_gamma[:, None]
    diff = idx[:, None] - idx[None, :]
    intra = jnp.where(diff >= 0, jnp.exp(lg[:, :, None] * jnp.maximum(diff, 0.0)), 0.0)
    q_decay = jnp.exp(lg * (idx + 1.0))
    k_decay = jnp.exp(lg * (RET_CHUNK - 1.0 - idx))
    chunk_decay = jnp.exp(lg * RET_CHUNK)[..., None]

    def step(s, qkv):
        qc, kc, vc = qkv
        att = jnp.einsum('bhid,bhjd->bhij', qc, kc) * intra
        o = jnp.einsum('bhij,bhjv->bhiv', att, vc) + jnp.einsum('bhid,bhdv->bhiv', qc, s) * q_decay[..., None]
        s = s * chunk_decay + jnp.einsum('bhjd,hj,bhjv->bhdv', kc, k_decay, vc)
        return s, o

    s_fin, o = lax.scan(step, s0, (chunks(q), chunks(k), chunks(v)))
    return jnp.moveaxis(o, 0, 2).reshape(B, H, T, dv), s_fin


def bidir_retention(q, k, v, log_gamma, s0):
    def flip(t):
        return jnp.flip(t, 2)

    o, s = jax.vmap(retention_chunkwise)(jnp.stack([q, flip(q)]), jnp.stack([k, flip(k)]),
                                         jnp.stack([v, flip(v)]), log_gamma, s0)
    return o[0] + flip(o[1]), s


def mixer_ab(u, w_in, w_out, log_gamma, gn_g, gn_b, sink, ctx):
    B, T, _ = u.shape
    hr = H_RET * HEAD_DIM
    sizes = [hr, hr, hr, hr, H_WIN * HEAD_DIM, KV_WIN * HEAD_DIM]
    rq, rk, rv, rg, wq, wk, wv = jnp.split(u @ w_in, np.cumsum(sizes).tolist(), axis=-1)
    rq = rq.reshape(B, T, H_RET, HEAD_DIM)
    rk = rk.reshape(B, T, H_RET, HEAD_DIM)
    rv = rv.reshape(B, T, H_RET, HEAD_DIM)
    wq = wq.reshape(B, T, KV_WIN, G_WIN, HEAD_DIM)
    wk = wk.reshape(B, T, KV_WIN, HEAD_DIM)
    wv = wv.reshape(B, T, KV_WIN, HEAD_DIM)
    if ctx is None:
        s0 = jnp.zeros((2, B, H_RET, HEAD_DIM, HEAD_DIM), f32)
        wo = map_query_blocks(lambda qb, start: gqa_attend(qb, wk, wv, None, sink), wq)
    else:
        state, ck, cv = ctx
        cos, sin = axial_rope(T, HEAD_DIM)
        rq, rk = apply_rope(rq, cos, sin), apply_rope(rk, cos, sin)
        wq, wk = apply_rope(wq, cos, sin), apply_rope(wk, cos, sin)
        s0 = jnp.moveaxis(state.astype(f32), 1, 0)
        wo = window_attention_latent(wq, wk, wv, ck, cv, sink)

    def to_bh(t):
        return jnp.transpose(t, (0, 2, 1, 3)).astype(f32)

    ro, s_fin = bidir_retention(to_bh(rq), to_bh(rk) * (HEAD_DIM ** -0.5), to_bh(rv), log_gamma.astype(f32), s0)
    ro = layer_norm(ro)
    ro = jnp.transpose(ro, (0, 2, 1, 3)).reshape(B, T, hr) * gn_g.astype(f32) + gn_b.astype(f32)
    ro = jax.nn.silu(rg) * ro.astype(u.dtype)
    out = jnp.concatenate([ro, wo.reshape(B, T, -1)], -1) @ w_out
    return out, (jnp.moveaxis(s_fin, 0, 1), wk, wv)


def mixer_cd(u, w_in, w_out, lam, subln_g, lam_init, ctx):
    B, T, _ = u.shape
    qd = H_DIFF * 2 * HEAD_DIM
    dq, dk, dv, fz = jnp.split(u @ w_in, [qd, 2 * qd, 3 * qd], axis=-1)
    dq = dq.reshape(B, T, H_DIFF, 2, HEAD_DIM)
    dk = dk.reshape(B, T, H_DIFF, 2, HEAD_DIM)
    dv = dv.reshape(B, T, H_DIFF, 2 * HEAD_DIM)
    lam = lam.astype(f32)
    lam_full = jnp.exp(jnp.sum(lam[0] * lam[1])) - jnp.exp(jnp.sum(lam[2] * lam[3])) + lam_init
    if ctx is None:
        keys, vals = dk, dv
    else:
        ck, cv = ctx
        cos, sin = axial_rope(T, HEAD_DIM)
        dq, dk = apply_rope(dq, cos, sin), apply_rope(dk, cos, sin)
        keys = jnp.concatenate([dk, ck], 1)
        vals = jnp.concatenate([dv, cv], 1)

    def block(qb, start):
        s = jnp.einsum('bqhmd,bkhmd->bhmqk', qb, keys).astype(f32) * (HEAD_DIM ** -0.5)
        p = jax.nn.softmax(s, axis=-1)
        p = p[:, :, 0] - lam_full * p[:, :, 1]
        return jnp.einsum('bhqk,bkhe->bqhe', p.astype(vals.dtype), vals)

    a = map_query_blocks(block, dq)
    a = rms_norm(a, subln_g) * (1.0 - lam_init)
    z = fz.reshape(B, T, FNET_GROUPS, FNET_DIM).astype(f32)
    z = jnp.real(jnp.fft.fft2(z, axes=(1, 3), norm='ortho')).astype(u.dtype)
    out = jnp.concatenate([a.reshape(B, T, -1), z.reshape(B, T, -1)], -1) @ w_out
    return out, (dk, dv)


def swiglu(u, w_gate, w_up, w_down):
    return (jax.nn.silu(u @ w_gate) * (u @ w_up)) @ w_down


def trunk(x, cond, ctx_ab, ctx_cd, w_mod, b_mod, ln_g, ln_b, w_in_ab, w_out_ab, ret_log_gamma, ret_gn_g,
          ret_gn_b, win_sink, w_in_cd, w_out_cd, diff_lambda, diff_subln_g, w_gate, w_up, w_down):
    new_ab, new_cd = [], []
    for l in range(DEPTH):
        mod = jax.nn.silu(cond) @ w_mod[l] + b_mod[l]
        sh1, sc1, g1, sh2, sc2, g2 = jnp.split(mod[:, None, :], 6, axis=-1)
        u = layer_norm(x) * (1.0 + sc1) + sh1
        i = l // 2
        if l % 2 == 0:
            ctx = None if ctx_ab is None else tuple(t[:, i] for t in ctx_ab)
            h, new = mixer_ab(u, w_in_ab[i], w_out_ab[i], ret_log_gamma[i], ret_gn_g[i], ret_gn_b[i],
                              win_sink[i].reshape(KV_WIN, G_WIN), ctx)
            new_ab.append(new)
        else:
            ctx = None if ctx_cd is None else tuple(t[:, i] for t in ctx_cd)
            lam_init = 0.8 - 0.6 * math.exp(-0.3 * l)
            h, new = mixer_cd(u, w_in_cd[i], w_out_cd[i], diff_lambda[i], diff_subln_g[i], lam_init, ctx)
            new_cd.append(new)
        x = layer_norm(ALPHA * x + g1 * h, ln_g[l, 0], ln_b[l, 0])
        u = layer_norm(x) * (1.0 + sc2) + sh2
        x = layer_norm(ALPHA * x + g2 * swiglu(u, w_gate[l], w_up[l], w_down[l]), ln_g[l, 1], ln_b[l, 1])
    return x, new_ab, new_cd


def setup_inputs(seed: int = 0) -> dict:
    key = jax.random.key(seed)
    ks = jax.random.split(key, 32)

    def nrm(k, shape, s):
        return jax.random.normal(k, shape, f32) * s

    base_lg = jnp.log1p(-(2.0 ** (-5.0 - jnp.arange(H_RET, dtype=f32))))
    return {
        'x_prompt': nrm(ks[0], (BATCH, SEQ, D_MODEL), 1.0),
        'x_sample': nrm(ks[1], (DEC_BATCH, DEC_SEQ, D_MODEL), 1.0),
        'state_ret': nrm(ks[2], (DEC_BATCH, N_AB, 2, H_RET, HEAD_DIM, HEAD_DIM), 1.0),
        'cache_win_k': nrm(ks[3], (DEC_BATCH, N_AB, PAST_LEN, KV_WIN, HEAD_DIM), 1.0),
        'cache_win_v': nrm(ks[4], (DEC_BATCH, N_AB, PAST_LEN, KV_WIN, HEAD_DIM), 1.0),
        'cache_diff_k': nrm(ks[5], (DEC_BATCH, N_CD, PAST_LEN, H_DIFF, 2, HEAD_DIM), 1.0),
        'cache_diff_v': nrm(ks[6], (DEC_BATCH, N_CD, PAST_LEN, H_DIFF, 2 * HEAD_DIM), 1.0),
        'c': nrm(ks[7], (DEC_BATCH, D_MODEL), 1.0),
        'c_ctx': nrm(ks[8], (D_MODEL,), 1.0),
        'w_mod': nrm(ks[9], (DEPTH, D_MODEL, 6 * D_MODEL), D_MODEL ** -0.5),
        'b_mod': nrm(ks[10], (DEPTH, 6 * D_MODEL), 0.02),
        'ln_g': 1.0 + nrm(ks[11], (DEPTH, 2, D_MODEL), 0.02),
        'ln_b': nrm(ks[12], (DEPTH, 2, D_MODEL), 0.02),
        'w_in_ab': nrm(ks[13], (N_AB, D_MODEL, AB_IN), D_MODEL ** -0.5),
        'w_out_ab': nrm(ks[14], (N_AB, AB_OUT, D_MODEL), BETA * AB_OUT ** -0.5),
        'ret_log_gamma': base_lg * (1.0 + nrm(ks[15], (N_AB, 2, H_RET), 0.1)),
        'ret_gn_g': 1.0 + nrm(ks[16], (N_AB, H_RET * HEAD_DIM), 0.02),
        'ret_gn_b': nrm(ks[17], (N_AB, H_RET * HEAD_DIM), 0.02),
        'win_sink': nrm(ks[18], (N_AB, H_WIN), 1.0),
        'w_in_cd': nrm(ks[19], (N_CD, D_MODEL, CD_IN), D_MODEL ** -0.5),
        'w_out_cd': nrm(ks[20], (N_CD, CD_OUT, D_MODEL), BETA * CD_OUT ** -0.5),
        'diff_lambda': nrm(ks[21], (N_CD, 4, HEAD_DIM), 0.1),
        'diff_subln_g': 1.0 + nrm(ks[22], (N_CD, 2 * HEAD_DIM), 0.02),
        'w_gate': nrm(ks[23], (DEPTH, D_MODEL, D_FF), D_MODEL ** -0.5),
        'w_up': nrm(ks[24], (DEPTH, D_MODEL, D_FF), D_MODEL ** -0.5),
        'w_down': nrm(ks[25], (DEPTH, D_FF, D_MODEL), BETA * D_FF ** -0.5),
    }


def reference(x_prompt, x_sample, state_ret, cache_win_k, cache_win_v, cache_diff_k, cache_diff_v, c, c_ctx,
              w_mod, b_mod, ln_g, ln_b, w_in_ab, w_out_ab, ret_log_gamma, ret_gn_g, ret_gn_b, win_sink,
              w_in_cd, w_out_cd, diff_lambda, diff_subln_g, w_gate, w_up, w_down):
    weights = (w_mod, b_mod, ln_g, ln_b, w_in_ab, w_out_ab, ret_log_gamma, ret_gn_g, ret_gn_b, win_sink,
               w_in_cd, w_out_cd, diff_lambda, diff_subln_g, w_gate, w_up, w_down)
    y_prompt, new_ab, new_cd = trunk(x_prompt, c_ctx[None, :], None, None, *weights)
    y_sample, _, _ = trunk(x_sample, c, (state_ret, cache_win_k, cache_win_v), (cache_diff_k, cache_diff_v), *weights)
    new_state_ret = jnp.stack([n[0] for n in new_ab], axis=1)
    new_cache_win_k = jnp.stack([n[1] for n in new_ab], axis=1)
    new_cache_win_v = jnp.stack([n[2] for n in new_ab], axis=1)
    new_cache_diff_k = jnp.stack([n[0] for n in new_cd], axis=1)
    new_cache_diff_v = jnp.stack([n[1] for n in new_cd], axis=1)
    return (y_prompt, y_sample, new_state_ret, new_cache_win_k, new_cache_win_v, new_cache_diff_k, new_cache_diff_v)
```

```cpp
#if defined(HOST_TEST)
#include <cmath>
#include <cstdio>
#include <cstdlib>
#include <cstring>
#define HD inline
#else
#include <hip/hip_runtime.h>
#include <hip/hip_cooperative_groups.h>
#include <cstdio>
#define HD __host__ __device__ __forceinline__
#endif

#ifndef ONE_LAUNCH
#define ONE_LAUNCH 0
#endif

#ifdef CFG_SMALL
constexpr int D_MODEL = 128, BATCH = 3, SEQ = 256, DEC_BATCH = 2, DEC_SEQ = 384, PAST_LEN = 192;
constexpr int H_RET = 2, H_WIN = 4, KV_WIN = 2, H_DIFF = 2, FNET_GROUPS = 2, D_FF = 192;
#else
constexpr int D_MODEL = 1024, BATCH = 32, SEQ = 256, DEC_BATCH = 2, DEC_SEQ = 1024, PAST_LEN = 512;
constexpr int H_RET = 8, H_WIN = 8, KV_WIN = 2, H_DIFF = 6, FNET_GROUPS = 4, D_FF = 2816;
#endif
constexpr int DEPTH = 2, GRID_W = 64, HEAD_DIM = 64, G_WIN = H_WIN / KV_WIN, WINDOW = 128, FNET_DIM = 64;
constexpr int AB_IN = 4 * H_RET * HEAD_DIM + (H_WIN + 2 * KV_WIN) * HEAD_DIM, AB_OUT = (H_RET + H_WIN) * HEAD_DIM;
constexpr int CD_IN = 3 * H_DIFF * 2 * HEAD_DIM + FNET_GROUPS * FNET_DIM, CD_OUT = H_DIFF * 2 * HEAD_DIM + FNET_GROUPS * FNET_DIM;
constexpr int D = D_MODEL, D6 = 6 * D_MODEL, NCOND = 1 + DEC_BATCH;
constexpr int M_CTX = BATCH * SEQ, M_LAT = DEC_BATCH * DEC_SEQ, M_TOT = M_CTX + M_LAT;
constexpr float LN_EPS = 1e-5f;
constexpr float ALPHA = 1.41421356237309515f;
constexpr float LAM_INIT = 0.35550906759509316f;
constexpr int RQ_OFF = 0, RK_OFF = H_RET * 64, RV_OFF = 2 * H_RET * 64, RG_OFF = 3 * H_RET * 64, WQ_OFF = 4 * H_RET * 64, WK_OFF = WQ_OFF + H_WIN * 64, WV_OFF = WK_OFF + KV_WIN * 64;
constexpr int DQ_OFF = 0, DK_OFF = H_DIFF * 128, DV_OFF = 2 * H_DIFF * 128, FZ_OFF = 3 * H_DIFF * 128;
constexpr int QKV_LD = AB_IN > CD_IN ? AB_IN : CD_IN, MIX_LD = AB_OUT > CD_OUT ? AB_OUT : CD_OUT;
constexpr long O_YP = 0, O_YS = O_YP + (long)M_CTX * D, O_ST = O_YS + (long)M_LAT * D, O_WK = O_ST + (long)BATCH * 2 * H_RET * 4096,
               O_WV = O_WK + (long)M_CTX * KV_WIN * 64, O_DK = O_WV + (long)M_CTX * KV_WIN * 64, O_DV = O_DK + (long)M_CTX * H_DIFF * 128,
               O_END = O_DV + (long)M_CTX * H_DIFF * 128;

struct P {
    const float *x_prompt, *x_sample, *state_ret, *cwk, *cwv, *cdk, *cdv, *c, *c_ctx, *w_mod, *b_mod, *ln_g, *ln_b, *w_in_ab, *w_out_ab, *ret_lg, *gn_g, *gn_b,
        *sink, *w_in_cd, *w_out_cd, *lam, *subln, *w_gate, *w_up, *w_down;
    float* out;
    float *mod, *u, *qkv, *mix, *y, *xr, *hid, *fa, *fb;
};
constexpr size_t WS_MOD = 0, WS_U = WS_MOD + (size_t)NCOND * DEPTH * D6, WS_QKV = WS_U + (size_t)M_TOT * D, WS_MIX = WS_QKV + (size_t)M_TOT * QKV_LD,
                 WS_Y = WS_MIX + (size_t)M_TOT * MIX_LD, WS_XR = WS_Y + (size_t)M_TOT * D, WS_HID = WS_XR + (size_t)M_TOT * D,
                 WS_FA = WS_HID + (size_t)M_TOT * D_FF, WS_FB = WS_FA + (size_t)M_TOT * FNET_GROUPS * 64, WS_END = WS_FB + (size_t)M_TOT * FNET_GROUPS * 64;

HD float silu_f(float v) { return v / (1.0f + expf(-v)); }
HD const float* xin_row(const P& p, int m) { return m < M_CTX ? p.x_prompt + (size_t)m * D : p.x_sample + (size_t)(m - M_CTX) * D; }
HD int cond_of(int m) { return m < M_CTX ? 0 : 1 + (m - M_CTX) / DEC_SEQ; }
HD const float* mod_ptr(const P& p, int ci, int l, int chunk) { return p.mod + ((size_t)ci * DEPTH + l) * D6 + (size_t)chunk * D; }
HD void tok_geom(int m, int& base, int& t, int& T, int& b, bool& lat) {
    if (m < M_CTX) { b = m / SEQ; t = m % SEQ; T = SEQ; base = m - t; lat = false; }
    else { const int r = m - M_CTX; b = r / DEC_SEQ; t = r % DEC_SEQ; T = DEC_SEQ; base = m - t; lat = true; }
}

HD void ph_mod(const P& p, long idx) {
    const int j = (int)(idx % D6); const int l = (int)((idx / D6) % DEPTH); const int ci = (int)(idx / ((long)D6 * DEPTH));
    const float* cv = ci == 0 ? p.c_ctx : p.c + (size_t)(ci - 1) * D;
    const float* w = p.w_mod + (size_t)l * D * D6 + j;
    float acc = 0.f;
    for (int k = 0; k < D; ++k) acc += silu_f(cv[k]) * w[(size_t)k * D6];
    p.mod[((size_t)ci * DEPTH + l) * D6 + j] = acc + p.b_mod[(size_t)l * D6 + j];
}
HD void row_stats(const float* r, float& mu, float& rstd) {
    float s = 0.f; for (int i = 0; i < D; ++i) s += r[i];
    mu = s / D; float q = 0.f; for (int i = 0; i < D; ++i) { const float d = r[i] - mu; q += d * d; }
    rstd = 1.0f / sqrtf(q / D + LN_EPS);
}
HD void ph_lnmod0(const P& p, long idx) {
    const int m = (int)idx; const float* r = xin_row(p, m); float mu, rs; row_stats(r, mu, rs);
    const int ci = cond_of(m); const float* sh = mod_ptr(p, ci, 0, 0); const float* sc = mod_ptr(p, ci, 0, 1);
    float* u = p.u + (size_t)m * D;
    for (int i = 0; i < D; ++i) u[i] = (r[i] - mu) * rs * (1.0f + sc[i]) + sh[i];
}
HD void rowpass(const P& p, int m, int lnrow, int ml, int shc, int scc) {
    float* y = p.y + (size_t)m * D; float* xr = p.xr + (size_t)m * D; float* u = p.u + (size_t)m * D;
    float mu, rs; row_stats(y, mu, rs);
    const float* g = p.ln_g + (size_t)lnrow * D; const float* b = p.ln_b + (size_t)lnrow * D;
    for (int i = 0; i < D; ++i) xr[i] = (y[i] - mu) * rs * g[i] + b[i];
    row_stats(xr, mu, rs);
    const int ci = cond_of(m); const float* sh = mod_ptr(p, ci, ml, shc); const float* sc = mod_ptr(p, ci, ml, scc);
    for (int i = 0; i < D; ++i) u[i] = (xr[i] - mu) * rs * (1.0f + sc[i]) + sh[i];
}
HD void ph_final(const P& p, long idx) {
    const int m = (int)idx; const float* y = p.y + (size_t)m * D; float mu, rs; row_stats(y, mu, rs);
    const float* g = p.ln_g + (size_t)3 * D; const float* b = p.ln_b + (size_t)3 * D;
    float* o = m < M_CTX ? p.out + O_YP + (size_t)m * D : p.out + O_YS + (size_t)(m - M_CTX) * D;
    for (int i = 0; i < D; ++i) o[i] = (y[i] - mu) * rs * g[i] + b[i];
}
HD void dot4(const float* A, int lda, const float* B, int ldb, int K, int n, float (&acc)[4]) {
    acc[0] = acc[1] = acc[2] = acc[3] = 0.f;
    for (int k = 0; k < K; ++k) { const float b = B[(size_t)k * ldb + n];
        acc[0] += A[k] * b; acc[1] += A[lda + k] * b; acc[2] += A[2 * lda + k] * b; acc[3] += A[3 * lda + k] * b; }
}
template <int N, int K_> HD void gemm_plain(const float* A, int lda, const float* B, float* C, int ldc, long idx) {
    const int n = (int)(idx % N), m0 = (int)(idx / N) * 4; float acc[4]; dot4(A + (size_t)m0 * lda, lda, B, N, K_, n, acc);
    for (int r = 0; r < 4; ++r) C[(size_t)(m0 + r) * ldc + n] = acc[r];
}
template <int K_> HD void gemm_res(const P& p, const float* A, int lda, const float* B, bool first, int ml, int gchunk, long idx) {
    const int n = (int)(idx % D), m0 = (int)(idx / D) * 4; float acc[4]; dot4(A + (size_t)m0 * lda, lda, B, D, K_, n, acc);
    for (int r = 0; r < 4; ++r) { const int m = m0 + r; const float res = first ? xin_row(p, m)[n] : p.xr[(size_t)m * D + n];
        p.y[(size_t)m * D + n] = ALPHA * res + mod_ptr(p, cond_of(m), ml, gchunk)[n] * acc[r]; }
}
HD void gemm_ffn1(const P& p, int l, long idx) {
    const int n = (int)(idx % D_FF), m0 = (int)(idx / D_FF) * 4; float a[4], b[4];
    dot4(p.u + (size_t)m0 * D, D, p.w_gate + (size_t)l * D * D_FF, D_FF, D, n, a); dot4(p.u + (size_t)m0 * D, D, p.w_up + (size_t)l * D * D_FF, D_FF, D, n, b);
    for (int r = 0; r < 4; ++r) p.hid[(size_t)(m0 + r) * D_FF + n] = silu_f(a[r]) * b[r];
}
HD void rope_item(float* row, int colbase, int t, int i) {
    const int r = t / GRID_W, c = t % GRID_W; const int q = i & 15;
    const float inv = powf(10000.0f, -(float)q / 16.0f); const float ang = (i < 16 ? (float)r : (float)c) * inv;
    const float cs = cosf(ang), sn = sinf(ang); const float x1 = row[colbase + i], x2 = row[colbase + 32 + i];
    row[colbase + i] = x1 * cs - x2 * sn; row[colbase + 32 + i] = x1 * sn + x2 * cs;
}
constexpr int ROPE_AB_SLOTS = 2 * H_RET + H_WIN + KV_WIN, ROPE_CD_SLOTS = 4 * H_DIFF;
HD void ph_rope_ab(const P& p, long idx) {
    const int i = (int)(idx % 32); const int s = (int)((idx / 32) % ROPE_AB_SLOTS); const int ml = (int)(idx / (32 * ROPE_AB_SLOTS));
    const int m = M_CTX + ml, t = ml % DEC_SEQ;
    int col; if (s < 2 * H_RET) col = RQ_OFF + s * 64; else col = WQ_OFF + (s - 2 * H_RET) * 64;
    rope_item(p.qkv + (size_t)m * QKV_LD, col, t, i);
}
HD void ph_rope_cd(const P& p, long idx) {
    const int i = (int)(idx % 32); const int s = (int)((idx / 32) % ROPE_CD_SLOTS); const int ml = (int)(idx / (32 * ROPE_CD_SLOTS));
    const int m = M_CTX + ml, t = ml % DEC_SEQ;
    rope_item(p.qkv + (size_t)m * QKV_LD, DQ_OFF + s * 64, t, i);
}
HD void ph_copy_win(const P& p, long idx) {
    const int c = (int)(idx % (KV_WIN * 64)); const int m = (int)(idx / (KV_WIN * 64));
    p.out[O_WK + idx] = p.qkv[(size_t)m * QKV_LD + WK_OFF + c]; p.out[O_WV + idx] = p.qkv[(size_t)m * QKV_LD + WV_OFF + c];
}
HD void ph_copy_diff(const P& p, long idx) {
    const int c = (int)(idx % (H_DIFF * 128)); const int m = (int)(idx / (H_DIFF * 128));
    p.out[O_DK + idx] = p.qkv[(size_t)m * QKV_LD + DK_OFF + c]; p.out[O_DV + idx] = p.qkv[(size_t)m * QKV_LD + DV_OFF + c];
}
HD float dot64(const float (&q)[64], const float* k) {
    float s = 0.f;
#pragma unroll
    for (int d = 0; d < 64; ++d) s += q[d] * k[d];
    return s;
}
HD void ph_win(const P& p, long idx) {
    const int hq = (int)(idx % H_WIN), m = (int)(idx / H_WIN), kv = hq / G_WIN;
    int base, t, T, b; bool lat; tok_geom(m, base, t, T, b, lat);
    float q[64];
#pragma unroll
    for (int d = 0; d < 64; ++d) q[d] = p.qkv[(size_t)m * QKV_LD + WQ_OFF + hq * 64 + d];
    const int j0 = lat ? (t - WINDOW < 0 ? 0 : t - WINDOW) : 0, j1 = lat ? (t + WINDOW > T - 1 ? T - 1 : t + WINDOW) : T - 1;
    const int nc = lat ? PAST_LEN : 0;
    const float* ck = p.cwk + ((size_t)b * PAST_LEN) * (KV_WIN * 64) + kv * 64; const float* cv = p.cwv + ((size_t)b * PAST_LEN) * (KV_WIN * 64) + kv * 64;
    const float snk = p.sink[hq]; float mx = snk;
    for (int j = j0; j <= j1; ++j) { const float s = dot64(q, p.qkv + (size_t)(base + j) * QKV_LD + WK_OFF + kv * 64) * 0.125f; mx = fmaxf(mx, s); }
    for (int j = 0; j < nc; ++j) { const float s = dot64(q, ck + (size_t)j * (KV_WIN * 64)) * 0.125f; mx = fmaxf(mx, s); }
    float den = expf(snk - mx); float o[64];
#pragma unroll
    for (int d = 0; d < 64; ++d) o[d] = 0.f;
    for (int j = j0; j <= j1; ++j) { const float* kr = p.qkv + (size_t)(base + j) * QKV_LD; const float e = expf(dot64(q, kr + WK_OFF + kv * 64) * 0.125f - mx); den += e;
        const float* vr = kr + WV_OFF + kv * 64;
#pragma unroll
        for (int d = 0; d < 64; ++d) o[d] += e * vr[d]; }
    for (int j = 0; j < nc; ++j) { const float e = expf(dot64(q, ck + (size_t)j * (KV_WIN * 64)) * 0.125f - mx); den += e; const float* vr = cv + (size_t)j * (KV_WIN * 64);
#pragma unroll
        for (int d = 0; d < 64; ++d) o[d] += e * vr[d]; }
    const float inv = 1.0f / den;
#pragma unroll
    for (int d = 0; d < 64; ++d) p.mix[(size_t)m * MIX_LD + H_RET * 64 + hq * 64 + d] = o[d] * inv;
}
HD void ph_ret(const P& p, long idx) {
    const int h = (int)(idx % H_RET), m = (int)(idx / H_RET);
    int base, t, T, b; bool lat; tok_geom(m, base, t, T, b, lat);
    const float lgf = p.ret_lg[h], lgb = p.ret_lg[H_RET + h];
    float q[64], o[64];
#pragma unroll
    for (int d = 0; d < 64; ++d) { q[d] = p.qkv[(size_t)m * QKV_LD + RQ_OFF + h * 64 + d]; o[d] = 0.f; }
    for (int j = 0; j < T; ++j) { const float* kr = p.qkv + (size_t)(base + j) * QKV_LD; const float s = dot64(q, kr + RK_OFF + h * 64) * 0.125f;
        const int df = t - j; const float dec = df > 0 ? expf(lgf * (float)df) : (df < 0 ? expf(lgb * (float)(-df)) : 2.0f); const float w = s * dec;
        const float* vr = kr + RV_OFF + h * 64;
#pragma unroll
        for (int d = 0; d < 64; ++d) o[d] += w * vr[d]; }
    if (lat) { const float cf = expf(lgf * (float)(t + 1)), cb = expf(lgb * (float)(T - t));
        const float* sf = p.state_ret + (((size_t)b * 2 + 0) * H_RET + h) * 4096; const float* sb = p.state_ret + (((size_t)b * 2 + 1) * H_RET + h) * 4096;
        for (int d = 0; d < 64; ++d) { const float qd = p.qkv[(size_t)m * QKV_LD + RQ_OFF + h * 64 + d]; const float qf = qd * cf, qb = qd * cb;
#pragma unroll
            for (int v = 0; v < 64; ++v) o[v] += qf * sf[d * 64 + v] + qb * sb[d * 64 + v]; } }
    float mu = 0.f;
#pragma unroll
    for (int d = 0; d < 64; ++d) mu += o[d];
    mu *= (1.0f / 64.0f); float var = 0.f;
#pragma unroll
    for (int d = 0; d < 64; ++d) { const float dd = o[d] - mu; var += dd * dd; }
    const float rs = 1.0f / sqrtf(var * (1.0f / 64.0f) + LN_EPS);
#pragma unroll
    for (int d = 0; d < 64; ++d) { const float yv = (o[d] - mu) * rs * p.gn_g[h * 64 + d] + p.gn_b[h * 64 + d];
        p.mix[(size_t)m * MIX_LD + h * 64 + d] = silu_f(p.qkv[(size_t)m * QKV_LD + RG_OFF + h * 64 + d]) * yv; }
}
HD void ph_state(const P& p, long idx) {
    const int v = (int)(idx % 64), d = (int)((idx / 64) % 64), h = (int)((idx / 4096) % H_RET), dir = (int)((idx / (4096 * H_RET)) % 2), b = (int)(idx / (4096 * H_RET * 2));
    const float lg = p.ret_lg[dir * H_RET + h]; float acc = 0.f;
    for (int j = 0; j < SEQ; ++j) { const float* r = p.qkv + (size_t)(b * SEQ + j) * QKV_LD; const float w = expf(lg * (float)(dir == 0 ? SEQ - 1 - j : j));
        acc += w * (r[RK_OFF + h * 64 + d] * 0.125f) * r[RV_OFF + h * 64 + v]; }
    p.out[O_ST + idx] = acc;
}
HD void ph_diff(const P& p, long idx) {
    const int h = (int)(idx % H_DIFF), m = (int)(idx / H_DIFF);
    int base, t, T, b; bool lat; tok_geom(m, base, t, T, b, lat);
    const int nc = lat ? PAST_LEN : 0;
    float l01 = 0.f, l23 = 0.f;
    for (int d = 0; d < 64; ++d) { l01 += p.lam[d] * p.lam[64 + d]; l23 += p.lam[128 + d] * p.lam[192 + d]; }
    const float lam_full = expf(l01) - expf(l23) + LAM_INIT;
    float q1[64], q2[64];
#pragma unroll
    for (int d = 0; d < 64; ++d) { q1[d] = p.qkv[(size_t)m * QKV_LD + DQ_OFF + h * 128 + d]; q2[d] = p.qkv[(size_t)m * QKV_LD + DQ_OFF + h * 128 + 64 + d]; }
    const float* ck = p.cdk + ((size_t)b * PAST_LEN) * (H_DIFF * 128) + h * 128; const float* cv = p.cdv + ((size_t)b * PAST_LEN) * (H_DIFF * 128) + h * 128;
    float mx1 = -INFINITY, mx2 = -INFINITY;
    for (int j = 0; j < T + nc; ++j) { const float* kr = j < T ? p.qkv + (size_t)(base + j) * QKV_LD + DK_OFF + h * 128 : ck + (size_t)(j - T) * (H_DIFF * 128);
        mx1 = fmaxf(mx1, dot64(q1, kr) * 0.125f); mx2 = fmaxf(mx2, dot64(q2, kr + 64) * 0.125f); }
    float den1 = 0.f, den2 = 0.f;
    for (int j = 0; j < T + nc; ++j) { const float* kr = j < T ? p.qkv + (size_t)(base + j) * QKV_LD + DK_OFF + h * 128 : ck + (size_t)(j - T) * (H_DIFF * 128);
        den1 += expf(dot64(q1, kr) * 0.125f - mx1); den2 += expf(dot64(q2, kr + 64) * 0.125f - mx2); }
    const float i1 = 1.0f / den1, i2 = lam_full / den2;
    float ss = 0.f; float* orow = p.mix + (size_t)m * MIX_LD + h * 128;
    for (int ec = 0; ec < 2; ++ec) {
        float o[64];
#pragma unroll
        for (int e = 0; e < 64; ++e) o[e] = 0.f;
        for (int j = 0; j < T + nc; ++j) { const float* kr = j < T ? p.qkv + (size_t)(base + j) * QKV_LD + DK_OFF + h * 128 : ck + (size_t)(j - T) * (H_DIFF * 128);
            const float* vr = j < T ? p.qkv + (size_t)(base + j) * QKV_LD + DV_OFF + h * 128 : cv + (size_t)(j - T) * (H_DIFF * 128);
            const float w = expf(dot64(q1, kr) * 0.125f - mx1) * i1 - expf(dot64(q2, kr + 64) * 0.125f - mx2) * i2;
#pragma unroll
            for (int e = 0; e < 64; ++e) o[e] += w * vr[ec * 64 + e]; }
#pragma unroll
        for (int e = 0; e < 64; ++e) { ss += o[e] * o[e]; orow[ec * 64 + e] = o[e]; }
    }
    const float rs = (1.0f - LAM_INIT) / sqrtf(ss * (1.0f / 128.0f) + LN_EPS);
    for (int e = 0; e < 128; ++e) orow[e] = orow[e] * rs * p.subln[e];
}
HD void ph_four1(const P& p, long idx) {
    const int mm = (int)(idx % 64), g = (int)((idx / 64) % FNET_GROUPS), m = (int)(idx / (64 * FNET_GROUPS));
    const float* z = p.qkv + (size_t)m * QKV_LD + FZ_OFF + g * 64; float a = 0.f, b = 0.f;
    for (int c = 0; c < 64; ++c) { const float ang = 6.283185307179586f * (float)((mm * c) & 63) * (1.0f / 64.0f); a += z[c] * cosf(ang); b += z[c] * sinf(ang); }
    p.fa[(size_t)m * (FNET_GROUPS * 64) + g * 64 + mm] = a; p.fb[(size_t)m * (FNET_GROUPS * 64) + g * 64 + mm] = b;
}
HD void ph_four2(const P& p, long idx) {
    const int mm = (int)(idx % 64), g = (int)((idx / 64) % FNET_GROUPS), m = (int)(idx / (64 * FNET_GROUPS));
    int base, k, T, b; bool lat; tok_geom(m, base, k, T, b, lat);
    float acc = 0.f;
    for (int t = 0; t < T; ++t) { const float ang = 6.283185307179586f * (float)((k * t) % T) / (float)T; const size_t o = (size_t)(base + t) * (FNET_GROUPS * 64) + g * 64 + mm;
        acc += cosf(ang) * p.fa[o] - sinf(ang) * p.fb[o]; }
    p.mix[(size_t)m * MIX_LD + H_DIFF * 128 + g * 64 + mm] = acc / sqrtf((float)T * 64.0f);
}

constexpr int N_PHASES = 24;
HD long phase_count(int ph) {
    switch (ph) {
        case 0: return (long)NCOND * DEPTH * D6;
        case 1: case 9: case 12: case 20: case 23: return M_TOT;
        case 2: return (long)(M_TOT / 4) * AB_IN;
        case 3: return (long)M_LAT * ROPE_AB_SLOTS * 32;
        case 4: return (long)M_CTX * KV_WIN * 64;
        case 5: return (long)M_TOT * H_WIN;
        case 6: return (long)M_TOT * H_RET;
        case 7: return (long)BATCH * 2 * H_RET * 4096;
        case 8: case 11: case 19: case 22: return (long)(M_TOT / 4) * D;
        case 10: case 21: return (long)(M_TOT / 4) * D_FF;
        case 13: return (long)(M_TOT / 4) * CD_IN;
        case 14: return (long)M_LAT * ROPE_CD_SLOTS * 32;
        case 15: return (long)M_CTX * H_DIFF * 128;
        case 16: return (long)M_TOT * H_DIFF;
        case 17: case 18: return (long)M_TOT * FNET_GROUPS * 64;
    }
    return 0;
}
template <int PH> HD void phase_item(const P& p, long idx) {
    if constexpr (PH == 0) ph_mod(p, idx);
    else if constexpr (PH == 1) ph_lnmod0(p, idx);
    else if constexpr (PH == 2) gemm_plain<AB_IN, D>(p.u, D, p.w_in_ab, p.qkv, QKV_LD, idx);
    else if constexpr (PH == 3) ph_rope_ab(p, idx);
    else if constexpr (PH == 4) ph_copy_win(p, idx);
    else if constexpr (PH == 5) ph_win(p, idx);
    else if constexpr (PH == 6) ph_ret(p, idx);
    else if constexpr (PH == 7) ph_state(p, idx);
    else if constexpr (PH == 8) gemm_res<AB_OUT>(p, p.mix, MIX_LD, p.w_out_ab, true, 0, 2, idx);
    else if constexpr (PH == 9) rowpass(p, (int)idx, 0, 0, 3, 4);
    else if constexpr (PH == 10) gemm_ffn1(p, 0, idx);
    else if constexpr (PH == 11) gemm_res<D_FF>(p, p.hid, D_FF, p.w_down, false, 0, 5, idx);
    else if constexpr (PH == 12) rowpass(p, (int)idx, 1, 1, 0, 1);
    else if constexpr (PH == 13) gemm_plain<CD_IN, D>(p.u, D, p.w_in_cd, p.qkv, QKV_LD, idx);
    else if constexpr (PH == 14) ph_rope_cd(p, idx);
    else if constexpr (PH == 15) ph_copy_diff(p, idx);
    else if constexpr (PH == 16) ph_diff(p, idx);
    else if constexpr (PH == 17) ph_four1(p, idx);
    else if constexpr (PH == 18) ph_four2(p, idx);
    else if constexpr (PH == 19) gemm_res<CD_OUT>(p, p.mix, MIX_LD, p.w_out_cd, false, 1, 2, idx);
    else if constexpr (PH == 20) rowpass(p, (int)idx, 2, 1, 3, 4);
    else if constexpr (PH == 21) gemm_ffn1(p, 1, idx);
    else if constexpr (PH == 22) gemm_res<D_FF>(p, p.hid, D_FF, p.w_down + (size_t)D_FF * D, false, 1, 5, idx);
    else if constexpr (PH == 23) ph_final(p, idx);
}

HD P make_params(void* const* d_in, void* d_out, void* d_ws) {
    P p{}; const float* const* in = (const float* const*)d_in;
    p.x_prompt = in[0]; p.x_sample = in[1]; p.state_ret = in[2]; p.cwk = in[3]; p.cwv = in[4]; p.cdk = in[5]; p.cdv = in[6]; p.c = in[7]; p.c_ctx = in[8];
    p.w_mod = in[9]; p.b_mod = in[10]; p.ln_g = in[11]; p.ln_b = in[12]; p.w_in_ab = in[13]; p.w_out_ab = in[14]; p.ret_lg = in[15]; p.gn_g = in[16]; p.gn_b = in[17];
    p.sink = in[18]; p.w_in_cd = in[19]; p.w_out_cd = in[20]; p.lam = in[21]; p.subln = in[22]; p.w_gate = in[23]; p.w_up = in[24]; p.w_down = in[25];
    p.out = (float*)d_out; float* ws = (float*)d_ws;
    p.mod = ws + WS_MOD; p.u = ws + WS_U; p.qkv = ws + WS_QKV; p.mix = ws + WS_MIX; p.y = ws + WS_Y; p.xr = ws + WS_XR; p.hid = ws + WS_HID; p.fa = ws + WS_FA; p.fb = ws + WS_FB;
    return p;
}

#if defined(HOST_TEST)
template <int PH> void run_phase_host(const P& p) {
    const long n = phase_count(PH);
#pragma omp parallel for schedule(dynamic, 64)
    for (long i = 0; i < n; ++i) phase_item<PH>(p, i);
}
template <int PH> void run_all_host(const P& p) { run_phase_host<PH>(p); if constexpr (PH + 1 < N_PHASES) run_all_host<PH + 1>(p); }
#else
namespace cg = cooperative_groups;
constexpr int NT = 256;
template <int PH> __device__ __forceinline__ void run_phase_dev(const P& p) {
    const long n = phase_count(PH); const long stride = (long)gridDim.x * NT;
    for (long i = (long)blockIdx.x * NT + threadIdx.x; i < n; i += stride) phase_item<PH>(p, i);
}
template <int PH> __global__ void __launch_bounds__(NT) phase_kernel(P p) { run_phase_dev<PH>(p); }
template <int PH> __device__ __forceinline__ void run_from(const P& p, cg::grid_group& grid) {
    run_phase_dev<PH>(p);
    if constexpr (PH + 1 < N_PHASES) { grid.sync(); run_from<PH + 1>(p, grid); }
}
__global__ void __launch_bounds__(NT) mega_kernel(P p) { cg::grid_group grid = cg::this_grid(); run_from<0>(p, grid); }

template <int PH> static void launch_all(const P& p, hipStream_t stream) {
    const long n = phase_count(PH); long blocks = (n + NT - 1) / NT; if (blocks > 65536) blocks = 65536;
    hipLaunchKernelGGL(phase_kernel<PH>, dim3((unsigned)blocks), dim3(NT), 0, stream, p);
    if constexpr (PH + 1 < N_PHASES) launch_all<PH + 1>(p, stream);
}
extern "C" void kernel_launch(void* const* d_in, const int* in_sizes, int n_in, void* d_out, int out_size, void* d_ws, size_t ws_size, hipStream_t stream) {
    if (n_in != 26 || (long)out_size != O_END || ws_size < WS_END * sizeof(float)) { fprintf(stderr, "kernel_launch: unexpected shapes (n_in %d out %d ws %zu)\n", n_in, out_size, ws_size); return; }
    P p = make_params(d_in, d_out, d_ws);
#if ONE_LAUNCH
    static int grid_blocks = 0;
    if (!grid_blocks) { int dev = 0, cus = 0, per_cu = 0; hipGetDevice(&dev); hipDeviceGetAttribute(&cus, hipDeviceAttributeMultiprocessorCount, dev);
        hipOccupancyMaxActiveBlocksPerMultiprocessor(&per_cu, mega_kernel, NT, 0); if (per_cu < 1) per_cu = 1; grid_blocks = cus * per_cu; }
    void* args[] = {&p};
    hipError_t e = hipLaunchCooperativeKernel((void*)mega_kernel, dim3(grid_blocks), dim3(NT), args, 0, stream);
    if (e != hipSuccess) fprintf(stderr, "cooperative launch failed: %s (grid %d)\n", hipGetErrorString(e), grid_blocks);
#else
    launch_all<0>(p, stream);
#endif
}
#endif
```
